# Optimizing an MI355X kernel written in HIP

```python
import math
import jax, jax.numpy as jnp
from jax import lax
import numpy as np

D_MODEL = 1024
BATCH = 8
SEQ = 2048
DEPTH = 1

N_META = 16
DA_HEADS = 4
DA_HEAD_DIM = 64
DA_V_DIM = 2 * DA_HEAD_DIM
DA_QK_WIDTH = DA_HEADS * 2 * DA_HEAD_DIM
DA_V_WIDTH = DA_HEADS * DA_V_DIM
ROPE_THETA = 10000.0
Q_BLOCK = 128
CONV_CH = D_MODEL // 2
CONV_WIDTH = 31
N_EXPERTS = 256
TOP_K = 8
N_GROUPS = 8
TOPK_GROUPS = 4
EXPERT_HIDDEN = D_MODEL // 4
SHARED_HIDDEN = D_MODEL // 4
ROUTED_SCALE = 2.5
MOE_BLOCK = 128
LN_EPS = 1e-5
DEEPNORM_ALPHA = (2.0 * DEPTH) ** 0.25
DEEPNORM_BETA = (8.0 * DEPTH) ** -0.25
SPLIT_POINTS = (DA_QK_WIDTH,
                2 * DA_QK_WIDTH,
                2 * DA_QK_WIDTH + DA_V_WIDTH,
                2 * DA_QK_WIDTH + DA_V_WIDTH + CONV_CH,
                2 * DA_QK_WIDTH + DA_V_WIDTH + 2 * CONV_CH,
                2 * DA_QK_WIDTH + DA_V_WIDTH + 2 * CONV_CH + D_MODEL)
IN_WIDTH = 2 * DA_QK_WIDTH + DA_V_WIDTH + 2 * CONV_CH + 2 * D_MODEL

kernel_name = 'hybrid_diffattn_conformer_moe_deepnorm'


def layer_norm(x, g, b):
    xf = x.astype(jnp.float32)
    mu = jnp.mean(xf, axis=-1, keepdims=True)
    var = jnp.mean(jnp.square(xf - mu), axis=-1, keepdims=True)
    y = (xf - mu) * lax.rsqrt(var + LN_EPS) * g.astype(jnp.float32) + b.astype(jnp.float32)
    return y.astype(x.dtype)


def rms_norm(x, g):
    xf = x.astype(jnp.float32)
    y = xf * lax.rsqrt(jnp.mean(jnp.square(xf), axis=-1, keepdims=True) + LN_EPS) * g.astype(jnp.float32)
    return y.astype(x.dtype)


def rope_tables(n, dim):
    inv = 1.0 / (ROPE_THETA ** (jnp.arange(0, dim, 2, dtype=jnp.float32) / dim))
    ang = jnp.arange(n, dtype=jnp.float32)[:, None] * inv[None, :]
    return jnp.cos(ang), jnp.sin(ang)


def apply_rope(x, cos, sin):
    x1, x2 = jnp.split(x, 2, axis=-1)
    c = cos.astype(x.dtype)
    s = sin.astype(x.dtype)
    return jnp.concatenate([x1 * c - x2 * s, x2 * c + x1 * s], axis=-1)


def diff_attention(q, k, v, lam, lam_init, subln_g):
    bsz, seq_len = q.shape[0], q.shape[1]
    n_blk = -(-seq_len // Q_BLOCK)
    lp = n_blk * Q_BLOCK
    pad = lp - seq_len
    q = jnp.pad(q, ((0, 0), (0, pad), (0, 0), (0, 0), (0, 0)))
    k = jnp.pad(k, ((0, 0), (0, pad), (0, 0), (0, 0), (0, 0)))
    v = jnp.pad(v, ((0, 0), (0, pad), (0, 0), (0, 0)))
    q = jnp.transpose(q, (0, 2, 3, 1, 4))
    k = jnp.transpose(k, (0, 2, 3, 1, 4))
    v = jnp.transpose(v, (0, 2, 1, 3))
    cos, sin = rope_tables(lp, DA_HEAD_DIM)
    q = apply_rope(q, cos, sin) * (DA_HEAD_DIM ** -0.5)
    k = apply_rope(k, cos, sin)
    key_pos = jnp.arange(lp)

    def q_block(i):
        start = i * Q_BLOCK
        qi = lax.dynamic_slice_in_dim(q, start, Q_BLOCK, axis=3)
        s = jnp.einsum('bhcqd,bhckd->bhcqk', qi, k).astype(jnp.float32)
        q_pos = start + jnp.arange(Q_BLOCK)
        causal = key_pos[None, :] <= q_pos[:, None]
        p = jax.nn.softmax(jnp.where(causal, s, -jnp.inf), axis=-1)
        a = p[:, :, 0] - lam * p[:, :, 1]
        return jnp.einsum('bhqk,bhkv->bhqv', a.astype(v.dtype), v)

    o = lax.map(q_block, jnp.arange(n_blk))
    o = jnp.transpose(o, (1, 0, 3, 2, 4)).reshape(bsz, lp, DA_HEADS, DA_V_DIM)[:, :seq_len]
    o = rms_norm(o, subln_g) * (1.0 - lam_init)
    return o.reshape(bsz, seq_len, DA_V_WIDTH)


def conformer_conv(glu_a, glu_b, conv_w, conv_b, ln_g, ln_b, w_o, b_o):
    u = glu_a * jax.nn.sigmoid(glu_b)
    y = lax.conv_general_dilated(u, conv_w[:, None, :].astype(u.dtype), window_strides=(1,),
                                 padding=[(CONV_WIDTH - 1, 0)],
                                 dimension_numbers=('NWC', 'WIO', 'NWC'),
                                 feature_group_count=CONV_CH) + conv_b
    y = jax.nn.silu(layer_norm(y, ln_g, ln_b))
    return y @ w_o + b_o


def moe_ffn(h, w_router, router_bias, w_gate_e, w_up_e, w_down_e, w_gate_s, w_up_s, w_down_s):
    n_tok, d = h.shape
    scores = jax.nn.sigmoid((h @ w_router).astype(jnp.float32))
    sel = scores + router_bias.astype(jnp.float32)
    grp = sel.reshape(n_tok, N_GROUPS, N_EXPERTS // N_GROUPS)
    grp_score = jnp.sum(lax.top_k(grp, 2)[0], axis=-1)
    _, top_g = lax.top_k(grp_score, TOPK_GROUPS)
    gmask = jnp.any(top_g[:, :, None] == jnp.arange(N_GROUPS)[None, None, :], axis=1)
    emask = jnp.repeat(gmask, N_EXPERTS // N_GROUPS, axis=1)
    _, top_e = lax.top_k(jnp.where(emask, sel, -jnp.inf), TOP_K)
    gw = jnp.take_along_axis(scores, top_e, axis=-1)
    gw = gw / jnp.sum(gw, axis=-1, keepdims=True) * ROUTED_SCALE

    n_assign = n_tok * TOP_K
    flat_e = top_e.reshape(-1)
    flat_tok = jnp.repeat(jnp.arange(n_tok, dtype=jnp.int32), TOP_K)
    flat_w = gw.reshape(-1)
    order = jnp.argsort(flat_e)
    se = flat_e[order]
    counts = jnp.bincount(flat_e, length=N_EXPERTS)
    padded = (counts + MOE_BLOCK - 1) // MOE_BLOCK * MOE_BLOCK
    start = jnp.cumsum(counts) - counts
    pend = jnp.cumsum(padded)
    pstart = pend - padded
    dest = pstart[se] + jnp.arange(n_assign) - start[se]
    n_rows = -(-(n_assign + N_EXPERTS * (MOE_BLOCK - 1)) // MOE_BLOCK) * MOE_BLOCK
    n_blocks = n_rows // MOE_BLOCK
    row_tok = jnp.full((n_rows,), n_tok, jnp.int32).at[dest].set(flat_tok[order])
    row_w = jnp.zeros((n_rows,), jnp.float32).at[dest].set(flat_w[order])
    blk_e = jnp.minimum(jnp.searchsorted(pend, jnp.arange(n_blocks) * MOE_BLOCK, side='right'), N_EXPERTS - 1)
    h_pad = jnp.concatenate([h, jnp.zeros((1, d), h.dtype)], axis=0)

    def expert_block(args):
        tok, e = args
        xb = h_pad[tok]
        return (jax.nn.silu(xb @ w_gate_e[e]) * (xb @ w_up_e[e])) @ w_down_e[e]

    y = lax.map(expert_block, (row_tok.reshape(n_blocks, MOE_BLOCK), blk_e))
    y = y.reshape(n_rows, d) * row_w[:, None].astype(y.dtype)
    routed = jax.ops.segment_sum(y, row_tok, num_segments=n_tok + 1)[:n_tok]
    shared = (jax.nn.silu(h @ w_gate_s) * (h @ w_up_s)) @ w_down_s
    return routed + shared


def setup_inputs(seed: int = 0) -> dict:
    key = jax.random.key(seed)
    ks = jax.random.split(key, 32)
    f32 = jnp.float32
    D = D_MODEL
    L_ = DEPTH

    def nrm(k, shape, scale):
        return jax.random.normal(k, shape, f32) * scale

    col_scale = jnp.concatenate([jnp.ones((2 * DA_QK_WIDTH,), f32),
                                 jnp.full((DA_V_WIDTH + CONV_CH,), DEEPNORM_BETA, f32),
                                 jnp.ones((CONV_CH + 2 * D,), f32)])
    return {
        'x': nrm(ks[0], (BATCH, SEQ, D), 1.0),
        'meta_tokens': nrm(ks[1], (N_META, D), 1.0),
        'ln_in_g': 1.0 + nrm(ks[2], (D,), 0.02),
        'ln_in_b': nrm(ks[3], (D,), 0.02),
        'w_in': nrm(ks[4], (L_, D, IN_WIDTH), D ** -0.5) * col_scale,
        'lambda_q1': nrm(ks[5], (L_, DA_HEAD_DIM), 0.1),
        'lambda_k1': nrm(ks[6], (L_, DA_HEAD_DIM), 0.1),
        'lambda_q2': nrm(ks[7], (L_, DA_HEAD_DIM), 0.1),
        'lambda_k2': nrm(ks[8], (L_, DA_HEAD_DIM), 0.1),
        'subln_g': 1.0 + nrm(ks[9], (L_, DA_V_DIM), 0.02),
        'w_attn_o': nrm(ks[10], (L_, DA_V_WIDTH, D), DA_V_WIDTH ** -0.5 * DEEPNORM_BETA),
        'conv_w': nrm(ks[11], (L_, CONV_WIDTH, CONV_CH), CONV_WIDTH ** -0.5),
        'conv_b': nrm(ks[12], (L_, CONV_CH), 0.02),
        'conv_ln_g': 1.0 + nrm(ks[13], (L_, CONV_CH), 0.02),
        'conv_ln_b': nrm(ks[14], (L_, CONV_CH), 0.02),
        'w_conv_o': nrm(ks[15], (L_, CONV_CH, D), CONV_CH ** -0.5 * DEEPNORM_BETA),
        'b_conv_o': nrm(ks[16], (L_, D), 0.02),
        'w_out': nrm(ks[17], (L_, D, D), D ** -0.5 * DEEPNORM_BETA),
        'ln1_g': 1.0 + nrm(ks[18], (L_, D), 0.02),
        'ln1_b': nrm(ks[19], (L_, D), 0.02),
        'w_router': nrm(ks[20], (L_, D, N_EXPERTS), D ** -0.5),
        'router_bias': nrm(ks[21], (L_, N_EXPERTS), 0.01),
        'w_gate_e': nrm(ks[22], (L_, N_EXPERTS, D, EXPERT_HIDDEN), D ** -0.5 * DEEPNORM_BETA),
        'w_up_e': nrm(ks[23], (L_, N_EXPERTS, D, EXPERT_HIDDEN), D ** -0.5 * DEEPNORM_BETA),
        'w_down_e': nrm(ks[24], (L_, N_EXPERTS, EXPERT_HIDDEN, D), EXPERT_HIDDEN ** -0.5 * DEEPNORM_BETA),
        'w_gate_s': nrm(ks[25], (L_, D, SHARED_HIDDEN), D ** -0.5 * DEEPNORM_BETA),
        'w_up_s': nrm(ks[26], (L_, D, SHARED_HIDDEN), D ** -0.5 * DEEPNORM_BETA),
        'w_down_s': nrm(ks[27], (L_, SHARED_HIDDEN, D), SHARED_HIDDEN ** -0.5 * DEEPNORM_BETA),
        'ln2_g': 1.0 + nrm(ks[28], (L_, D), 0.02),
        'ln2_b': nrm(ks[29], (L_, D), 0.02),
    }


def reference(x, meta_tokens, ln_in_g, ln_in_b, w_in, lambda_q1, lambda_k1, lambda_q2, lambda_k2,
              subln_g, w_attn_o, conv_w, conv_b, conv_ln_g, conv_ln_b, w_conv_o, b_conv_o, w_out,
              ln1_g, ln1_b, w_router, router_bias, w_gate_e, w_up_e, w_down_e, w_gate_s, w_up_s,
              w_down_s, ln2_g, ln2_b):
    bsz, seq, d = x.shape
    meta = jnp.broadcast_to(meta_tokens[None].astype(x.dtype), (bsz, N_META, d))
    h = layer_norm(jnp.concatenate([meta, x], axis=1), ln_in_g, ln_in_b)
    seq_len = seq + N_META
    for l in range(DEPTH):
        lam_init = 0.8 - 0.6 * math.exp(-0.3 * l)
        proj = h @ w_in[l]
        q, k, v, glu_a, glu_b, g_attn, g_conv = jnp.split(proj, SPLIT_POINTS, axis=-1)
        q = q.reshape(bsz, seq_len, DA_HEADS, 2, DA_HEAD_DIM)
        k = k.reshape(bsz, seq_len, DA_HEADS, 2, DA_HEAD_DIM)
        v = v.reshape(bsz, seq_len, DA_HEADS, DA_V_DIM)
        lam = (jnp.exp(jnp.sum(lambda_q1[l].astype(jnp.float32) * lambda_k1[l].astype(jnp.float32)))
               - jnp.exp(jnp.sum(lambda_q2[l].astype(jnp.float32) * lambda_k2[l].astype(jnp.float32)))
               + lam_init)
        y_attn = diff_attention(q, k, v, lam, lam_init, subln_g[l]) @ w_attn_o[l]
        y_conv = conformer_conv(glu_a, glu_b, conv_w[l], conv_b[l], conv_ln_g[l], conv_ln_b[l],
                                w_conv_o[l], b_conv_o[l])
        merged = jax.nn.sigmoid(g_attn) * y_attn + jax.nn.sigmoid(g_conv) * y_conv
        h = layer_norm(DEEPNORM_ALPHA * h + merged @ w_out[l], ln1_g[l], ln1_b[l])
        m = moe_ffn(h.reshape(bsz * seq_len, d), w_router[l], router_bias[l], w_gate_e[l], w_up_e[l],
                    w_down_e[l], w_gate_s[l], w_up_s[l], w_down_s[l]).reshape(bsz, seq_len, d)
        h = layer_norm(DEEPNORM_ALPHA * h + m, ln2_g[l], ln2_b[l])
    return h[:, N_META:]
```

```cpp
#include <hip/hip_runtime.h>
#include <stdint.h>
#include <cstdio>

typedef unsigned short bf16_t;
typedef float f32x4 __attribute__((ext_vector_type(4)));

constexpr int NB = 8, SEQ = 2048, DM = 1024, NMETA = 16, LSEQ = SEQ + NMETA  , LK = 2112  , TOK = NB * SEQ  ;
constexpr int XN_ROWS = 16640;
constexpr int INW = 4608, NEXP = 256, EH = 256, TOPK = 8;
constexpr float LN_EPS = 1e-5f;
constexpr float ALPHA = 1.189207115002721f;
constexpr float LAM_INIT = 0.2f;
constexpr float QSCALE = 0.125f * 1.4426950408889634f;
constexpr int LIST_CAP = 16384;

constexpr size_t MiB = 1u << 20;
constexpr size_t WS_CTL = 0;
constexpr size_t WS_XN = 2 * MiB;
constexpr size_t WS_RT = 36 * MiB;
constexpr size_t WS_Q = 40 * MiB;
constexpr size_t WS_K = 56 * MiB;
constexpr size_t WS_V = 73 * MiB;
constexpr size_t WS_U = 90 * MiB;
constexpr size_t WS_G = 107 * MiB;
constexpr size_t WS_AOCA = 171 * MiB;
constexpr size_t WS_MG = 203 * MiB;
constexpr size_t WS_H1 = 235 * MiB;
constexpr size_t WS_GW = 267 * MiB;
constexpr size_t WS_LIST = 269 * MiB;
constexpr size_t WS_HB = 286 * MiB;
constexpr size_t WS_YB = 374 * MiB;
constexpr size_t WS_PROJ = 374 * MiB;
constexpr size_t WS_T1 = 664 * MiB;
constexpr size_t WS_T2 = 728 * MiB;
constexpr size_t WS_LOG = 792 * MiB;
constexpr size_t WS_END = 808 * MiB;
constexpr int CW_LAM = 16;
constexpr int CW_CNT = 1024;

__device__ __forceinline__ unsigned f2bf(float f) { unsigned u = __builtin_bit_cast(unsigned, f); return (u + 0x7fffu + ((u >> 16) & 1u)) >> 16; }
__device__ __forceinline__ float bf2f(unsigned h) { return __builtin_bit_cast(float, h << 16); }
__device__ __forceinline__ float sigmoidf_(float x) { return 1.0f / (1.0f + __expf(-x)); }
__device__ __forceinline__ float wave_sum(float v) {
#pragma unroll
    for (int o = 1; o < 64; o <<= 1) v += __shfl_xor(v, o);
    return v;
}
__device__ __forceinline__ float wave_max(float v) {
#pragma unroll
    for (int o = 1; o < 64; o <<= 1) v = fmaxf(v, __shfl_xor(v, o));
    return v;
}
__device__ __forceinline__ float block_sum(float v, float* red, int nw) {
    v = wave_sum(v); const int w = threadIdx.x >> 6;
    __syncthreads(); if ((threadIdx.x & 63) == 0) red[w] = v; __syncthreads();
    float s = 0.f; for (int i = 0; i < nw; ++i) s += red[i];
    return s;
}
__device__ __forceinline__ float block_max(float v, float* red, int nw) {
    v = wave_max(v); const int w = threadIdx.x >> 6;
    __syncthreads(); if ((threadIdx.x & 63) == 0) red[w] = v; __syncthreads();
    float s = red[0]; for (int i = 1; i < nw; ++i) s = fmaxf(s, red[i]);
    return s;
}

__global__ void __launch_bounds__(256) k_ln_in(const float* x, const float* meta, const float* g, const float* b, bf16_t* XN) {
    const int row = blockIdx.x * 4 + (threadIdx.x >> 6), lane = threadIdx.x & 63;
    if (row >= TOK + NMETA) return;
    const float* src = row < TOK ? x + (size_t)row * DM : meta + (size_t)(row - TOK) * DM;
    f32x4 v[4]; float s = 0.f;
#pragma unroll
    for (int j = 0; j < 4; ++j) { v[j] = *(const f32x4*)(src + 4 * (lane + 64 * j)); s += (v[j].x + v[j].y) + (v[j].z + v[j].w); }
    const float mean = wave_sum(s) * (1.f / DM); float q = 0.f;
#pragma unroll
    for (int j = 0; j < 4; ++j) { v[j] = v[j] - mean; q += (v[j].x * v[j].x + v[j].y * v[j].y) + (v[j].z * v[j].z + v[j].w * v[j].w); }
    const float rstd = 1.0f / sqrtf(wave_sum(q) * (1.f / DM) + LN_EPS);
#pragma unroll
    for (int j = 0; j < 4; ++j) { const int c = 4 * (lane + 64 * j); const f32x4 gg = *(const f32x4*)(g + c), bb = *(const f32x4*)(b + c);
        const f32x4 y = v[j] * rstd * gg + bb;
        unsigned lo = f2bf(y.x) | (f2bf(y.y) << 16), hi = f2bf(y.z) | (f2bf(y.w) << 16);
        *(uint2*)(XN + (size_t)row * DM + c) = make_uint2(lo, hi); }
}
__global__ void __launch_bounds__(256) k_misc(unsigned char* ws, const float* lq1, const float* lk1, const float* lq2, const float* lk2) {
    const int gt = blockIdx.x * 256 + threadIdx.x, gn = gridDim.x * 256;
    { uint4* p = (uint4*)(ws + WS_XN + (size_t)(TOK + NMETA) * DM * 2); const int n = (XN_ROWS - TOK - NMETA) * DM * 2 / 16; for (int i = gt; i < n; i += gn) p[i] = make_uint4(0, 0, 0, 0); }
    { const int per = (LK - LSEQ) * 64 * 2 / 16; for (int i = gt; i < 64 * per; i += gn) { const int blk = i / per, o = i % per; ((uint4*)(ws + WS_K + ((size_t)blk * LK + LSEQ) * 64 * 2))[o] = make_uint4(0, 0, 0, 0); } }
    { const int per = (LK - LSEQ) * 128 * 2 / 16; for (int i = gt; i < 32 * per; i += gn) { const int blk = i / per, o = i % per; ((uint4*)(ws + WS_V + ((size_t)blk * LK + LSEQ) * 128 * 2))[o] = make_uint4(0, 0, 0, 0); } }
    { float2* rt = (float2*)(ws + WS_RT); for (int i = gt; i < LK * 32; i += gn) { const int pos = i >> 5, fi = i & 31;
        const float inv = 1.0f / powf(10000.0f, (float)(2 * fi) / 64.0f); const float ang = (float)pos * inv;
        const double rev = (double)ang * 0.15915494309189535; const double fr = rev - floor(rev); const float f = (float)fr;
        rt[i] = make_float2(__builtin_amdgcn_cosf(f), __builtin_amdgcn_sinf(f)); } }
    if (blockIdx.x == 0 && threadIdx.x < 64) { const int l = threadIdx.x; const float a = wave_sum(lq1[l] * lk1[l]), c = wave_sum(lq2[l] * lk2[l]);
        if (l == 0) ((float*)(ws + WS_CTL))[CW_LAM] = expf(a) - expf(c) + LAM_INIT; }
}
__global__ void __launch_bounds__(256) k_ngemm(const bf16_t* A, int lda, const float* B, int ldb, float* C, int ldc, int K) {
    __shared__ float As[16][68]; __shared__ float Bs[16][68];
    const int t = threadIdx.x, tx = t & 15, ty = t >> 4, m0 = blockIdx.y * 64, n0 = blockIdx.x * 64;
    float acc[4][4];
#pragma unroll
    for (int i = 0; i < 4; ++i)
#pragma unroll
        for (int j = 0; j < 4; ++j) acc[i][j] = 0.f;
    for (int k0 = 0; k0 < K; k0 += 16) {
        { const int r = t >> 2, kq = (t & 3) * 4; const uint2 a = *(const uint2*)(A + (size_t)(m0 + r) * lda + k0 + kq);
          As[kq + 0][r] = bf2f(a.x & 0xffffu); As[kq + 1][r] = bf2f(a.x >> 16); As[kq + 2][r] = bf2f(a.y & 0xffffu); As[kq + 3][r] = bf2f(a.y >> 16); }
        { const int kk = t >> 4, n4 = (t & 15) * 4; const f32x4 b = *(const f32x4*)(B + (size_t)(k0 + kk) * ldb + n0 + n4);
          Bs[kk][n4] = b.x; Bs[kk][n4 + 1] = b.y; Bs[kk][n4 + 2] = b.z; Bs[kk][n4 + 3] = b.w; }
        __syncthreads();
#pragma unroll
        for (int kk = 0; kk < 16; ++kk) { float a[4], b[4];
#pragma unroll
            for (int i = 0; i < 4; ++i) { a[i] = As[kk][ty * 4 + i]; b[i] = Bs[kk][tx * 4 + i]; }
#pragma unroll
            for (int i = 0; i < 4; ++i)
#pragma unroll
                for (int j = 0; j < 4; ++j) acc[i][j] += a[i] * b[j]; }
        __syncthreads();
    }
#pragma unroll
    for (int i = 0; i < 4; ++i) *(f32x4*)(C + (size_t)(m0 + ty * 4 + i) * ldc + n0 + tx * 4) = (f32x4){acc[i][0], acc[i][1], acc[i][2], acc[i][3]};
}
__global__ void __launch_bounds__(256) k_inproj_epi(const float* proj, unsigned char* ws) {
    const int row = blockIdx.x, t = threadIdx.x; const float* pr = proj + (size_t)row * INW;
    const float2* rt = (const float2*)(ws + WS_RT);
    bf16_t* Qb = (bf16_t*)(ws + WS_Q); bf16_t* Kb = (bf16_t*)(ws + WS_K); bf16_t* Vb = (bf16_t*)(ws + WS_V); bf16_t* U = (bf16_t*)(ws + WS_U); bf16_t* G = (bf16_t*)(ws + WS_G);
    const bool meta = row >= TOK; const int b = meta ? 0 : row / SEQ, s = meta ? 0 : row % SEQ, pos = meta ? row - TOK : s + NMETA;
    const int nb = meta ? NB : 1;
    { const int hm = t >> 5, d = t & 31; const float2 cs = rt[pos * 32 + d];
      if (!meta) { const float x1 = pr[hm * 64 + d], x2 = pr[hm * 64 + d + 32]; bf16_t* q = Qb + ((size_t)(b * 8 + hm) * SEQ + s) * 64;
          q[d] = (bf16_t)f2bf((x1 * cs.x - x2 * cs.y) * QSCALE); q[d + 32] = (bf16_t)f2bf((x2 * cs.x + x1 * cs.y) * QSCALE); }
      const float x1 = pr[512 + hm * 64 + d], x2 = pr[512 + hm * 64 + d + 32]; const unsigned o1 = f2bf(x1 * cs.x - x2 * cs.y), o2 = f2bf(x2 * cs.x + x1 * cs.y);
      for (int bb = 0; bb < nb; ++bb) { bf16_t* k = Kb + ((size_t)((b + bb) * 8 + hm) * LK + pos) * 64; k[d] = (bf16_t)o1; k[d + 32] = (bf16_t)o2; } }
    for (int c = t; c < 512; c += 256) { const unsigned v = f2bf(pr[1024 + c]); const int h = c >> 7, vd = c & 127;
        const unsigned u = f2bf(pr[1536 + c] * sigmoidf_(pr[2048 + c]));
        for (int bb = 0; bb < nb; ++bb) { Vb[((size_t)((b + bb) * 4 + h) * LK + pos) * 128 + vd] = (bf16_t)v; U[((size_t)(b + bb) * LSEQ + pos) * 512 + c] = (bf16_t)u; } }
    if (!meta) for (int c = t; c < 2048; c += 256) G[(size_t)row * 2048 + c] = (bf16_t)f2bf(sigmoidf_(pr[2560 + c]));
}
__global__ void __launch_bounds__(128) k_attn_naive(unsigned char* ws, const float* subln_g) {
    __shared__ float p1[LK], p2[LK]; __shared__ float qs[128]; __shared__ float red[2];
    const int s = blockIdx.x, h = blockIdx.y, b = blockIdx.z, t = threadIdx.x, pos = s + NMETA, nk = pos + 1;
    const bf16_t* Qb = (const bf16_t*)(ws + WS_Q); const bf16_t* Kb = (const bf16_t*)(ws + WS_K); const bf16_t* Vb = (const bf16_t*)(ws + WS_V);
    const float lam = ((const float*)(ws + WS_CTL))[CW_LAM];
    qs[t] = bf2f(Qb[((size_t)(b * 8 + h * 2 + (t >> 6)) * SEQ + s) * 64 + (t & 63)]);
    __syncthreads();
    float m1 = -1e30f, m2 = -1e30f;
    for (int k = t; k < nk; k += 128) {
        const bf16_t* k1 = Kb + ((size_t)(b * 8 + h * 2) * LK + k) * 64; const bf16_t* k2 = k1 + (size_t)LK * 64;
        float a1 = 0.f, a2 = 0.f;
        for (int d = 0; d < 64; ++d) { a1 += qs[d] * bf2f(k1[d]); a2 += qs[64 + d] * bf2f(k2[d]); }
        p1[k] = a1; p2[k] = a2; m1 = fmaxf(m1, a1); m2 = fmaxf(m2, a2);
    }
    m1 = block_max(m1, red, 2); m2 = block_max(m2, red, 2);
    float l1 = 0.f, l2 = 0.f;
    for (int k = t; k < nk; k += 128) { const float e1 = exp2f(p1[k] - m1), e2 = exp2f(p2[k] - m2); p1[k] = e1; p2[k] = e2; l1 += e1; l2 += e2; }
    l1 = block_sum(l1, red, 2); l2 = block_sum(l2, red, 2);
    __syncthreads();
    float o1 = 0.f, o2 = 0.f; const bf16_t* v = Vb + ((size_t)(b * 4 + h) * LK) * 128 + t;
    for (int k = 0; k < nk; ++k) { const float vv = bf2f(v[(size_t)k * 128]); o1 += p1[k] * vv; o2 += p2[k] * vv; }
    const float o = o1 / l1 - lam * (o2 / l2);
    const float ss = block_sum(o * o, red, 2);
    const float y = o * (1.0f / sqrtf(ss * (1.f / 128.f) + LN_EPS)) * subln_g[t] * (1.0f - LAM_INIT);
    ((bf16_t*)(ws + WS_AOCA))[((size_t)(b * SEQ + s)) * 512 + h * 128 + t] = (bf16_t)f2bf(y);
}
__global__ void __launch_bounds__(512) k_conv_naive(unsigned char* ws, const float* cw, const float* cb, const float* lg, const float* lb) {
    __shared__ float red[8];
    const int m = blockIdx.x, b = m / SEQ, s = m % SEQ, pos = s + NMETA, c = threadIdx.x;
    const bf16_t* U = (const bf16_t*)(ws + WS_U) + (size_t)b * LSEQ * 512;
    float y = cb[c];
    for (int j = 0; j < 31; ++j) { const int p = pos - 30 + j; if (p >= 0) y += bf2f(U[(size_t)p * 512 + c]) * cw[j * 512 + c]; }
    const float mean = block_sum(y, red, 8) * (1.f / 512.f); const float d = y - mean;
    const float var = block_sum(d * d, red, 8) * (1.f / 512.f);
    const float z = d * (1.0f / sqrtf(var + LN_EPS)) * lg[c] + lb[c];
    ((bf16_t*)(ws + WS_AOCA))[(size_t)TOK * 512 + (size_t)m * 512 + c] = (bf16_t)f2bf(z * sigmoidf_(z));
}
__global__ void __launch_bounds__(256) k_merge_naive(unsigned char* ws, const float* bco) {
    const size_t i = (size_t)blockIdx.x * 256 + threadIdx.x; const int m = (int)(i >> 10), n = (int)(i & 1023);
    const bf16_t* G = (const bf16_t*)(ws + WS_G) + (size_t)m * 2048; const float* T1 = (const float*)(ws + WS_T1); const float* T2 = (const float*)(ws + WS_T2);
    ((bf16_t*)(ws + WS_MG))[i] = (bf16_t)f2bf(bf2f(G[n]) * T1[i] + bf2f(G[1024 + n]) * (T2[i] + bco[n]));
}
__global__ void __launch_bounds__(256) k_ln1_naive(unsigned char* ws, const float* g, const float* b) {
    const int row = blockIdx.x * 4 + (threadIdx.x >> 6), lane = threadIdx.x & 63;
    const bf16_t* xn = (const bf16_t*)(ws + WS_XN) + (size_t)row * DM; const float* pre = (const float*)(ws + WS_T1) + (size_t)row * DM;
    float v[16]; float s = 0.f;
#pragma unroll
    for (int j = 0; j < 16; ++j) { const int c = lane + 64 * j; v[j] = ALPHA * bf2f(xn[c]) + pre[c]; s += v[j]; }
    const float mean = wave_sum(s) * (1.f / DM); float q = 0.f;
#pragma unroll
    for (int j = 0; j < 16; ++j) { v[j] -= mean; q += v[j] * v[j]; }
    const float rstd = 1.0f / sqrtf(wave_sum(q) * (1.f / DM) + LN_EPS);
#pragma unroll
    for (int j = 0; j < 16; ++j) { const int c = lane + 64 * j; ((bf16_t*)(ws + WS_H1))[(size_t)row * DM + c] = (bf16_t)f2bf(v[j] * rstd * g[c] + b[c]); }
}
__global__ void __launch_bounds__(256) k_topk_naive(unsigned char* ws, const float* rbias) {
    const int tok = blockIdx.x * 256 + threadIdx.x; if (tok >= TOK) return;
    const float* lg = (const float*)(ws + WS_LOG) + (size_t)tok * NEXP;
    float gs0 = 0, gs1 = 0, gs2 = 0, gs3 = 0, gs4 = 0, gs5 = 0, gs6 = 0, gs7 = 0;
    for (int g = 0; g < 8; ++g) { float a = -1e30f, c = -1e30f;
        for (int j = 0; j < 32; ++j) { const float v = sigmoidf_(lg[g * 32 + j]) + rbias[g * 32 + j]; if (v > a) { c = a; a = v; } else if (v > c) c = v; }
        const float sc = a + c;
        gs0 = g == 0 ? sc : gs0; gs1 = g == 1 ? sc : gs1; gs2 = g == 2 ? sc : gs2; gs3 = g == 3 ? sc : gs3; gs4 = g == 4 ? sc : gs4; gs5 = g == 5 ? sc : gs5; gs6 = g == 6 ? sc : gs6; gs7 = g == 7 ? sc : gs7; }
    unsigned gmask = 0;
    for (int r = 0; r < 4; ++r) { float best = -1e30f; int bi = 0;
#define GSEL(i, v) if (!((gmask >> i) & 1u) && v > best) { best = v; bi = i; }
        GSEL(0, gs0) GSEL(1, gs1) GSEL(2, gs2) GSEL(3, gs3) GSEL(4, gs4) GSEL(5, gs5) GSEL(6, gs6) GSEL(7, gs7)
#undef GSEL
        gmask |= 1u << bi; }
    float pv = 1e30f; int pi = -1; float wsum = 0.f; int* cnt = (int*)(ws + WS_CTL) + CW_CNT; int* list = (int*)(ws + WS_LIST); float* gw = (float*)(ws + WS_GW) + (size_t)tok * 8;
    int sel_e[8]; float sel_w[8];
#pragma unroll
    for (int r = 0; r < 8; ++r) { float best = -1e30f; int bi = -1; float bsc = 0.f;
        for (int e = 0; e < NEXP; ++e) { if (!((gmask >> (e >> 5)) & 1u)) continue; const float sc = sigmoidf_(lg[e]); const float v = sc + rbias[e];
            const bool after = (v < pv) || (v == pv && e > pi); if (after && v > best) { best = v; bi = e; bsc = sc; } }
        pv = best; pi = bi; sel_e[r] = bi; sel_w[r] = bsc; wsum += bsc; }
#pragma unroll
    for (int r = 0; r < 8; ++r) { gw[r] = sel_w[r] / wsum * 2.5f; const int p = atomicAdd(&cnt[sel_e[r]], 1); list[(size_t)sel_e[r] * LIST_CAP + p] = tok * 8 + r; }
}
__global__ void __launch_bounds__(256) k_moe_naive(unsigned char* ws, const float* wg_e, const float* wu_e, const float* wd_e, const float* wg_s, const float* wu_s, const float* wd_s) {
    __shared__ float xs[8][1024]; __shared__ float hs[8][256];
    const int e = blockIdx.y, tile = blockIdx.x, t = threadIdx.x;
    const int* cnt = (const int*)(ws + WS_CTL) + CW_CNT; const int n = e < NEXP ? cnt[e] : TOK;
    if (tile * 8 >= n) return;
    const int* list = (const int*)(ws + WS_LIST) + (size_t)e * LIST_CAP; const float* gwp = (const float*)(ws + WS_GW);
    const float* wg = e < NEXP ? wg_e + (size_t)e * DM * EH : wg_s; const float* wu = e < NEXP ? wu_e + (size_t)e * DM * EH : wu_s; const float* wd = e < NEXP ? wd_e + (size_t)e * EH * DM : wd_s;
    const bf16_t* H1 = (const bf16_t*)(ws + WS_H1);
    int tk[8];
#pragma unroll
    for (int r = 0; r < 8; ++r) { const int i = tile * 8 + r; tk[r] = i < n ? (e < NEXP ? list[i] : i * 8) : -1; }
#pragma unroll
    for (int r = 0; r < 8; ++r) for (int c = t; c < 1024; c += 256) xs[r][c] = tk[r] >= 0 ? bf2f(H1[(size_t)(tk[r] >> 3) * DM + c]) : 0.f;
    __syncthreads();
    float ag[8], au[8];
#pragma unroll
    for (int r = 0; r < 8; ++r) { ag[r] = 0.f; au[r] = 0.f; }
    for (int k = 0; k < 1024; ++k) { const float g = wg[(size_t)k * EH + t], u = wu[(size_t)k * EH + t];
#pragma unroll
        for (int r = 0; r < 8; ++r) { ag[r] += xs[r][k] * g; au[r] += xs[r][k] * u; } }
#pragma unroll
    for (int r = 0; r < 8; ++r) hs[r][t] = ag[r] * sigmoidf_(ag[r]) * au[r];
    __syncthreads();
    for (int cc = 0; cc < 4; ++cc) { const int col = t + 256 * cc; float acc[8];
#pragma unroll
        for (int r = 0; r < 8; ++r) acc[r] = 0.f;
        for (int k = 0; k < 256; ++k) { const float w = wd[(size_t)k * DM + col];
#pragma unroll
            for (int r = 0; r < 8; ++r) acc[r] += hs[r][k] * w; }
#pragma unroll
        for (int r = 0; r < 8; ++r) if (tk[r] >= 0) { const int tok = tk[r] >> 3, slot = e < NEXP ? (tk[r] & 7) : 8; const float w = e < NEXP ? gwp[(size_t)tok * 8 + slot] : 1.0f;
            ((bf16_t*)(ws + WS_YB))[((size_t)tok * 9 + slot) * DM + col] = (bf16_t)f2bf(acc[r] * w); } }
}
__global__ void __launch_bounds__(256) k_final_naive(unsigned char* ws, const float* g, const float* b, float* out) {
    const int row = blockIdx.x * 4 + (threadIdx.x >> 6), lane = threadIdx.x & 63;
    const bf16_t* h1 = (const bf16_t*)(ws + WS_H1) + (size_t)row * DM; const bf16_t* yb = (const bf16_t*)(ws + WS_YB) + (size_t)row * 9 * DM;
    float v[16]; float s = 0.f;
#pragma unroll
    for (int j = 0; j < 16; ++j) { const int c = lane + 64 * j; float a = ALPHA * bf2f(h1[c]);
#pragma unroll
        for (int k = 0; k < 9; ++k) a += bf2f(yb[(size_t)k * DM + c]);
        v[j] = a; s += a; }
    const float mean = wave_sum(s) * (1.f / DM); float q = 0.f;
#pragma unroll
    for (int j = 0; j < 16; ++j) { v[j] -= mean; q += v[j] * v[j]; }
    const float rstd = 1.0f / sqrtf(wave_sum(q) * (1.f / DM) + LN_EPS);
#pragma unroll
    for (int j = 0; j < 16; ++j) { const int c = lane + 64 * j; out[(size_t)row * DM + c] = v[j] * rstd * g[c] + b[c]; }
}

extern "C" void kernel_launch(void* const* d_in, const int* in_sizes, int n_in, void* d_out, int out_size, void* d_ws, size_t ws_size, hipStream_t stream) {
    if (n_in != 30 || out_size != TOK * DM || ws_size < WS_END) { fprintf(stderr, "kernel_launch: unexpected sizes n_in %d out %d ws %zu\n", n_in, out_size, ws_size); return; }
    const float* const* in = (const float* const*)d_in;
    unsigned char* ws = (unsigned char*)d_ws;
    hipMemsetAsync(ws + WS_CTL, 0, 1 * MiB, stream);
    k_ln_in<<<(TOK + NMETA + 3) / 4, 256, 0, stream>>>(in[0], in[1], in[2], in[3], (bf16_t*)(ws + WS_XN));
    k_misc<<<256, 256, 0, stream>>>(ws, in[5], in[6], in[7], in[8]);
    k_ngemm<<<dim3(INW / 64, 16448 / 64), 256, 0, stream>>>((const bf16_t*)(ws + WS_XN), DM, in[4], INW, (float*)(ws + WS_PROJ), INW, DM);
    k_inproj_epi<<<TOK + NMETA, 256, 0, stream>>>((const float*)(ws + WS_PROJ), ws);
    k_attn_naive<<<dim3(SEQ, 4, NB), 128, 0, stream>>>(ws, in[9]);
    k_conv_naive<<<TOK, 512, 0, stream>>>(ws, in[11], in[12], in[13], in[14]);
    k_ngemm<<<dim3(DM / 64, TOK / 64), 256, 0, stream>>>((const bf16_t*)(ws + WS_AOCA), 512, in[10], DM, (float*)(ws + WS_T1), DM, 512);
    k_ngemm<<<dim3(DM / 64, TOK / 64), 256, 0, stream>>>((const bf16_t*)(ws + WS_AOCA) + (size_t)TOK * 512, 512, in[15], DM, (float*)(ws + WS_T2), DM, 512);
    k_merge_naive<<<TOK * DM / 256, 256, 0, stream>>>(ws, in[16]);
    k_ngemm<<<dim3(DM / 64, TOK / 64), 256, 0, stream>>>((const bf16_t*)(ws + WS_MG), DM, in[17], DM, (float*)(ws + WS_T1), DM, DM);
    k_ln1_naive<<<TOK / 4, 256, 0, stream>>>(ws, in[18], in[19]);
    k_ngemm<<<dim3(NEXP / 64, TOK / 64), 256, 0, stream>>>((const bf16_t*)(ws + WS_H1), DM, in[20], NEXP, (float*)(ws + WS_LOG), NEXP, DM);
    k_topk_naive<<<TOK / 256, 256, 0, stream>>>(ws, in[21]);
    k_moe_naive<<<dim3(TOK / 8, NEXP + 1), 256, 0, stream>>>(ws, in[22], in[23], in[24], in[25], in[26], in[27]);
    k_final_naive<<<TOK / 4, 256, 0, stream>>>(ws, in[28], in[29], (float*)d_out);
}
```
